# Optimizing an MI355X kernel written in HIP

```python
import math
import jax, jax.numpy as jnp
from jax import lax
import numpy as np

D_MODEL = 1024
BATCH = 8
SEQ = 2048
DEPTH = 1

DIFF_HEADS = 4
DIFF_HEAD_DIM = 64
DIFF_V_DIM = 2 * DIFF_HEAD_DIM
DIFF_QK_W = DIFF_HEADS * 2 * DIFF_HEAD_DIM
DIFF_V_W = DIFF_HEADS * DIFF_V_DIM
RET_HEADS = 4
RET_QK_DIM = 128
RET_V_DIM = 128
RET_QK_W = RET_HEADS * RET_QK_DIM
RET_V_W = RET_HEADS * RET_V_DIM
RET_CHUNK = 128
Q_BLOCK = 128
ROPE_THETA = 10000.0
NORM_EPS = 1e-6
D_MIX = DIFF_V_W + RET_V_W
IN_WIDTHS = [DIFF_QK_W, DIFF_QK_W, DIFF_V_W, DIFF_V_W, RET_QK_W, RET_QK_W, RET_V_W, RET_V_W]
D_IN_PROJ = sum(IN_WIDTHS)
IN_SPLITS = [int(v) for v in np.cumsum(IN_WIDTHS)[:-1]]

kernel_name = "hybrid_diffattn_retention_block"


def rmsnorm(x, w=None, eps=NORM_EPS):
    xf = x.astype(jnp.float32)
    y = xf * lax.rsqrt(jnp.mean(xf * xf, axis=-1, keepdims=True) + eps)
    if w is not None:
        y = y * w.astype(jnp.float32)
    return y.astype(x.dtype)


def rotary(x, positions, theta=ROPE_THETA):
    d = x.shape[-1]
    half = d // 2
    inv_freq = theta ** (-jnp.arange(half, dtype=jnp.float32) / half)
    ang = positions.astype(jnp.float32)[..., None] * inv_freq
    ang = ang.reshape(ang.shape[:2] + (1,) * (x.ndim - 3) + (half,))
    cos, sin = jnp.cos(ang), jnp.sin(ang)
    xf = x.astype(jnp.float32)
    x1, x2 = xf[..., :half], xf[..., half:]
    out = jnp.concatenate([x1 * cos - x2 * sin, x2 * cos + x1 * sin], axis=-1)
    return out.astype(x.dtype)


def diff_attention(q, k, v, positions, lam):
    B, S, _ = q.shape
    nb = S // Q_BLOCK
    q = rotary(q.reshape(B, S, DIFF_HEADS, 2, DIFF_HEAD_DIM), positions)
    k = rotary(k.reshape(B, S, DIFF_HEADS, 2, DIFF_HEAD_DIM), positions)
    scale = DIFF_HEAD_DIM ** -0.5
    qf = (q.astype(jnp.float32) * scale).transpose(0, 2, 3, 1, 4)
    q_blocks = jnp.moveaxis(qf.reshape(B, DIFF_HEADS, 2, nb, Q_BLOCK, DIFF_HEAD_DIM), 3, 0)
    kf = k.astype(jnp.float32).transpose(0, 2, 3, 1, 4)
    vf = v.astype(jnp.float32).reshape(B, S, DIFF_HEADS, DIFF_V_DIM).transpose(0, 2, 1, 3)
    key_pos = jnp.arange(S)

    def one_block(args):
        qb, blk = args
        s = jnp.einsum('bhcqd,bhckd->bhcqk', qb, kf)
        q_pos = blk * Q_BLOCK + jnp.arange(Q_BLOCK)
        causal = key_pos[None, :] <= q_pos[:, None]
        s = jnp.where(causal, s, jnp.float32(-1e30))
        p = jax.nn.softmax(s, axis=-1)
        a = p[:, :, 0] - lam * p[:, :, 1]
        return jnp.einsum('bhqk,bhkv->bhqv', a, vf)

    out = lax.map(one_block, (q_blocks, jnp.arange(nb)))
    out = out.transpose(1, 0, 3, 2, 4).reshape(B, S, DIFF_HEADS, DIFF_V_DIM)
    return out.astype(v.dtype)


def retention_chunkwise(q, k, v, positions):
    B, S, _ = q.shape
    n = S // RET_CHUNK
    C = RET_CHUNK
    q = rotary(q.reshape(B, S, RET_HEADS, RET_QK_DIM), positions)
    k = rotary(k.reshape(B, S, RET_HEADS, RET_QK_DIM), positions)

    def chunks(t, d):
        return t.astype(jnp.float32).reshape(B, n, C, RET_HEADS, d).transpose(0, 3, 1, 2, 4)

    qc = chunks(q, RET_QK_DIM)
    kc = chunks(k, RET_QK_DIM) * (RET_QK_DIM ** -0.5)
    vc = chunks(v.reshape(B, S, RET_HEADS, RET_V_DIM), RET_V_DIM)

    log_g = jnp.log(1.0 - 2.0 ** (-5.0 - jnp.arange(RET_HEADS, dtype=jnp.float32)))
    idx = jnp.arange(C, dtype=jnp.float32)
    diff = idx[:, None] - idx[None, :]
    decay_in = jnp.where(diff >= 0, jnp.exp(jnp.maximum(diff, 0.0)[None] * log_g[:, None, None]), 0.0)
    zeta = jnp.exp((C - 1 - idx)[None] * log_g[:, None])
    xi = jnp.exp((idx + 1)[None] * log_g[:, None])
    g_chunk = jnp.exp(C * log_g)

    s = jnp.einsum('bhncd,bhnmd->bhncm', qc, kc) * decay_in[None, :, None]
    inner = jnp.einsum('bhncm,bhnme->bhnce', s, vc)
    kv = jnp.einsum('bhncd,bhnce->bhnde', kc * zeta[None, :, None, :, None], vc)

    def step(R, kv_n):
        return g_chunk[None, :, None, None] * R + kv_n, R

    R0 = jnp.zeros((B, RET_HEADS, RET_QK_DIM, RET_V_DIM), jnp.float32)
    _, R_prev = lax.scan(step, R0, jnp.moveaxis(kv, 2, 0))
    R_prev = jnp.moveaxis(R_prev, 0, 2)
    cross = jnp.einsum('bhncd,bhnde->bhnce', qc * xi[None, :, None, :, None], R_prev)
    out = (inner + cross).transpose(0, 2, 3, 1, 4).reshape(B, S, RET_HEADS, RET_V_DIM)
    return out.astype(v.dtype)


def setup_inputs(seed: int = 0) -> dict:
    key = jax.random.key(seed)
    ks = jax.random.split(key, 12)
    x = jax.random.normal(ks[0], (BATCH, SEQ, D_MODEL), jnp.float32)
    offsets = jax.random.randint(ks[1], (BATCH, 1), 0, 4096, dtype=jnp.int32)
    positions = (offsets + jnp.arange(SEQ, dtype=jnp.int32)[None, :]).astype(jnp.int32)
    norm_pre_w = 1.0 + 0.01 * jax.random.normal(ks[2], (DEPTH, D_MODEL), jnp.float32)
    w_in = jax.random.normal(ks[3], (DEPTH, D_MODEL, D_IN_PROJ), jnp.float32) * D_MODEL ** -0.5
    lambda_q1 = 0.1 * jax.random.normal(ks[4], (DEPTH, DIFF_HEAD_DIM), jnp.float32)
    lambda_k1 = 0.1 * jax.random.normal(ks[5], (DEPTH, DIFF_HEAD_DIM), jnp.float32)
    lambda_q2 = 0.1 * jax.random.normal(ks[6], (DEPTH, DIFF_HEAD_DIM), jnp.float32)
    lambda_k2 = 0.1 * jax.random.normal(ks[7], (DEPTH, DIFF_HEAD_DIM), jnp.float32)
    diff_subln_w = 1.0 + 0.01 * jax.random.normal(ks[8], (DEPTH, DIFF_V_DIM), jnp.float32)
    w_out = jax.random.normal(ks[9], (DEPTH, D_MIX, D_MODEL), jnp.float32) * D_MIX ** -0.5
    norm_post_w = 1.0 + 0.01 * jax.random.normal(ks[10], (DEPTH, D_MODEL), jnp.float32)
    return {"x": x, "positions": positions, "norm_pre_w": norm_pre_w, "w_in": w_in,
            "lambda_q1": lambda_q1, "lambda_k1": lambda_k1, "lambda_q2": lambda_q2, "lambda_k2": lambda_k2,
            "diff_subln_w": diff_subln_w, "w_out": w_out, "norm_post_w": norm_post_w}


def reference(x, positions, norm_pre_w, w_in, lambda_q1, lambda_k1, lambda_q2, lambda_k2,
              diff_subln_w, w_out, norm_post_w):
    B, S, _ = x.shape
    h = x
    for layer in range(DEPTH):
        lambda_init = 0.8 - 0.6 * math.exp(-0.3 * layer)
        u = rmsnorm(h, norm_pre_w[layer])
        proj = jnp.einsum('bsd,de->bse', u, w_in[layer])
        dq, dk, dv, dg, rq, rk, rv, rg = jnp.split(proj, IN_SPLITS, axis=-1)

        lam = (jnp.exp(jnp.sum(lambda_q1[layer].astype(jnp.float32) * lambda_k1[layer].astype(jnp.float32)))
               - jnp.exp(jnp.sum(lambda_q2[layer].astype(jnp.float32) * lambda_k2[layer].astype(jnp.float32)))
               + lambda_init)
        y_a = diff_attention(dq, dk, dv, positions, lam)
        y_a = rmsnorm(y_a, diff_subln_w[layer]) * (1.0 - lambda_init)
        y_a = y_a.reshape(B, S, DIFF_V_W) * jax.nn.silu(dg)

        y_b = retention_chunkwise(rq, rk, rv, positions)
        y_b = rmsnorm(y_b).reshape(B, S, RET_V_W) * jax.nn.silu(rg)

        y = jnp.einsum('bsm,md->bsd', jnp.concatenate([y_a, y_b], axis=-1), w_out[layer])
        h = h + rmsnorm(y, norm_post_w[layer])
    return h
```

```cpp
#include <hip/hip_runtime.h>
#include <stdint.h>

namespace nv {
typedef unsigned short bf16_t;
constexpr int NB = 8, NS = 2048, ND = 1024, NM = NB * NS, NPROJ = 4096;

__device__ const double INV_FREQ64[64] = {
1.0, 0.8659643233600653, 0.7498942093324559, 0.6493816315762113, 0.5623413251903491, 0.4869675251658631, 0.4216965034285822, 0.3651741272548377, 0.31622776601683794, 0.27384196342643613, 0.23713737056616552, 0.2053525026457146, 0.1778279410038923, 0.1539926526059492, 0.1333521432163324, 0.11547819846894582, 0.09999999999999999, 0.08659643233600653, 0.07498942093324558, 0.06493816315762113, 0.056234132519034905, 0.04869675251658631, 0.042169650342858224, 0.03651741272548377, 0.03162277660168379, 0.02738419634264361, 0.023713737056616554, 0.02053525026457146, 0.01778279410038923, 0.015399265260594921, 0.013335214321633239, 0.011547819846894581, 0.01, 0.008659643233600654, 0.007498942093324559, 0.006493816315762113, 0.005623413251903491, 0.004869675251658631, 0.004216965034285822, 0.003651741272548377, 0.0031622776601683794, 0.0027384196342643613, 0.002371373705661655, 0.002053525026457146, 0.0017782794100389228, 0.0015399265260594918, 0.0013335214321633238, 0.0011547819846894581, 0.001, 0.0008659643233600654, 0.0007498942093324559, 0.0006493816315762113, 0.000562341325190349, 0.00048696752516586315, 0.00042169650342858224, 0.0003651741272548377, 0.00031622776601683794, 0.00027384196342643616, 0.00023713737056616554, 0.0002053525026457146, 0.0001778279410038923, 0.0001539926526059492, 0.0001333521432163324, 0.00011547819846894582};

__device__ __forceinline__ void rope_cs(int pos, int idx64, float& c, float& s) {
    double t = (double)pos * INV_FREQ64[idx64] * 0.15915494309189535;
    t -= __builtin_floor(t);
    const float a = (float)t * 6.283185307179586f;
    c = cosf(a); s = sinf(a);
}

template <typename T> __device__ __forceinline__ float ldf(const T* p);
template <> __device__ __forceinline__ float ldf<float>(const float* p) { return *p; }
template <> __device__ __forceinline__ float ldf<bf16_t>(const bf16_t* p) { return __uint_as_float(((unsigned)*p) << 16); }

__global__ __launch_bounds__(256) void n_prenorm(const float* __restrict__ x, const float* __restrict__ w, float* __restrict__ u) {
    const int row = blockIdx.x * 4 + (threadIdx.x >> 6), lane = threadIdx.x & 63;
    const float4* xr = (const float4*)(x + (size_t)row * ND); const float4* wr = (const float4*)w;
    float4 v[4]; float s = 0.f;
#pragma unroll
    for (int j = 0; j < 4; ++j) { v[j] = xr[lane + 64 * j]; s += v[j].x * v[j].x + v[j].y * v[j].y + v[j].z * v[j].z + v[j].w * v[j].w; }
#pragma unroll
    for (int o = 32; o >= 1; o >>= 1) s += __shfl_xor(s, o);
    const float r = 1.0f / sqrtf(s * (1.0f / ND) + 1e-6f);
    float4* ur = (float4*)(u + (size_t)row * ND);
#pragma unroll
    for (int j = 0; j < 4; ++j) { const float4 g = wr[lane + 64 * j]; float4 o; o.x = v[j].x * r * g.x; o.y = v[j].y * r * g.y; o.z = v[j].z * r * g.z; o.w = v[j].w * r * g.w; ur[lane + 64 * j] = o; }
}

template <typename TA>
__global__ __launch_bounds__(256) void n_gemm(const TA* __restrict__ A, int lda, const float* __restrict__ Bm, int ldb, float* __restrict__ C, int ldc, int K) {
    __shared__ float As[16][68];
    __shared__ float Bs[16][68];
    const int t = threadIdx.x, tx = t & 15, ty = t >> 4;
    const int m0 = blockIdx.y * 64, n0 = blockIdx.x * 64;
    float acc[4][4];
#pragma unroll
    for (int i = 0; i < 4; ++i)
#pragma unroll
        for (int j = 0; j < 4; ++j) acc[i][j] = 0.f;
    for (int k0 = 0; k0 < K; k0 += 16) {
        { const int r = t >> 2, kk = (t & 3) * 4; const TA* ap = A + (size_t)(m0 + r) * lda + k0 + kk;
          As[kk][r] = ldf<TA>(ap); As[kk + 1][r] = ldf<TA>(ap + 1); As[kk + 2][r] = ldf<TA>(ap + 2); As[kk + 3][r] = ldf<TA>(ap + 3); }
        { const int kk = t >> 4, n = (t & 15) * 4; const float4 v = *(const float4*)&Bm[(size_t)(k0 + kk) * ldb + n0 + n]; *(float4*)&Bs[kk][n] = v; }
        __syncthreads();
#pragma unroll
        for (int kk = 0; kk < 16; ++kk) {
            float a[4], b[4];
#pragma unroll
            for (int i = 0; i < 4; ++i) { a[i] = As[kk][ty * 4 + i]; b[i] = Bs[kk][tx * 4 + i]; }
#pragma unroll
            for (int i = 0; i < 4; ++i)
#pragma unroll
                for (int j = 0; j < 4; ++j) acc[i][j] += a[i] * b[j];
        }
        __syncthreads();
    }
#pragma unroll
    for (int i = 0; i < 4; ++i) { float4 o; o.x = acc[i][0]; o.y = acc[i][1]; o.z = acc[i][2]; o.w = acc[i][3]; *(float4*)&C[(size_t)(m0 + ty * 4 + i) * ldc + n0 + tx * 4] = o; }
}

__global__ __launch_bounds__(256) void n_rotary(float* __restrict__ P, int pitch, const int* __restrict__ pos, int G) {
    const size_t idx = (size_t)blockIdx.x * 256 + threadIdx.x; const int row = (int)(idx >> 9), p = (int)(idx & 511);
    const int half = G / 2, g = p / half, i = p % half;
    float c, s; rope_cs(pos[row], G == 128 ? i : 2 * i, c, s);
    float* a = P + (size_t)row * pitch + g * G + i; const float x1 = a[0], x2 = a[half];
    a[0] = x1 * c - x2 * s; a[half] = x2 * c + x1 * s;
}

template <typename T>
__global__ __launch_bounds__(256) void n_diffattn(const T* __restrict__ P, int pitch, int cq, int ck, int cv, float sscale,
                                                  const float* __restrict__ lq1, const float* __restrict__ lk1, const float* __restrict__ lq2, const float* __restrict__ lk2,
                                                  float* __restrict__ raw) {
    const int b = blockIdx.z >> 2, h = blockIdx.z & 3, es = blockIdx.y, i = blockIdx.x * 256 + threadIdx.x;
    float d1 = 0.f, d2 = 0.f;
    for (int t = 0; t < 64; ++t) { d1 += lq1[t] * lk1[t]; d2 += lq2[t] * lk2[t]; }
    const float lam = expf(d1) - expf(d2) + 0.2f;
    const T* base = P + (size_t)b * NS * pitch;
    float q0[64], q1[64];
#pragma unroll
    for (int d = 0; d < 64; ++d) { q0[d] = ldf<T>(base + (size_t)i * pitch + cq + h * 128 + d) * sscale; q1[d] = ldf<T>(base + (size_t)i * pitch + cq + h * 128 + 64 + d) * sscale; }
    const int jmax = blockIdx.x * 256 + 255;
    float m0 = -1e30f, l0 = 0.f, m1 = -1e30f, l1 = 0.f;
    for (int j = 0; j <= jmax; ++j) {
        const T* kr = base + (size_t)j * pitch + ck + h * 128; float s0 = 0.f, s1 = 0.f;
#pragma unroll
        for (int d = 0; d < 64; ++d) { s0 += q0[d] * ldf<T>(kr + d); s1 += q1[d] * ldf<T>(kr + 64 + d); }
        if (j <= i) { float mn = fmaxf(m0, s0); l0 = l0 * expf(m0 - mn) + expf(s0 - mn); m0 = mn; mn = fmaxf(m1, s1); l1 = l1 * expf(m1 - mn) + expf(s1 - mn); m1 = mn; }
    }
    const float il0 = 1.f / l0, il1 = lam / l1;
    float o[32];
#pragma unroll
    for (int e = 0; e < 32; ++e) o[e] = 0.f;
    for (int j = 0; j <= jmax; ++j) {
        const T* kr = base + (size_t)j * pitch + ck + h * 128; float s0 = 0.f, s1 = 0.f;
#pragma unroll
        for (int d = 0; d < 64; ++d) { s0 += q0[d] * ldf<T>(kr + d); s1 += q1[d] * ldf<T>(kr + 64 + d); }
        const float a = (j <= i) ? (expf(s0 - m0) * il0 - expf(s1 - m1) * il1) : 0.f;
        const T* vr = base + (size_t)j * pitch + cv + h * 128 + es * 32;
#pragma unroll
        for (int e = 0; e < 32; ++e) o[e] += a * ldf<T>(vr + e);
    }
    float* orow = raw + (size_t)(b * NS + i) * 512 + h * 128 + es * 32;
#pragma unroll
    for (int e = 0; e < 32; ++e) orow[e] = o[e];
}

template <typename T>
__global__ __launch_bounds__(256) void n_ret(const T* __restrict__ P, int pitch, int cq, int ck, int cv, float sscale, float* __restrict__ raw) {
    const int b = blockIdx.z >> 2, h = blockIdx.z & 3, es = blockIdx.y, i = blockIdx.x * 256 + threadIdx.x;
    const float l2g = log2f(1.0f - exp2f(-5.0f - (float)h));
    const T* base = P + (size_t)b * NS * pitch;
    float q[128];
#pragma unroll
    for (int d = 0; d < 128; ++d) q[d] = ldf<T>(base + (size_t)i * pitch + cq + h * 128 + d) * sscale;
    const int jmax = blockIdx.x * 256 + 255;
    float o[32];
#pragma unroll
    for (int e = 0; e < 32; ++e) o[e] = 0.f;
    for (int j = 0; j <= jmax; ++j) {
        const T* kr = base + (size_t)j * pitch + ck + h * 128; float s = 0.f;
#pragma unroll
        for (int d = 0; d < 128; ++d) s += q[d] * ldf<T>(kr + d);
        const float a = (j <= i) ? s * exp2f((float)(i - j) * l2g) : 0.f;
        const T* vr = base + (size_t)j * pitch + cv + h * 128 + es * 32;
#pragma unroll
        for (int e = 0; e < 32; ++e) o[e] += a * ldf<T>(vr + e);
    }
    float* orow = raw + (size_t)(b * NS + i) * 512 + h * 128 + es * 32;
#pragma unroll
    for (int e = 0; e < 32; ++e) orow[e] = o[e];
}

template <typename T>
__global__ __launch_bounds__(256) void n_post(const float* __restrict__ raw, const T* __restrict__ G, int gpitch, int gcol, int gate_is_silu,
                                              const float* __restrict__ subw, int mode, float* __restrict__ Y, int ycol) {
    const int idx = blockIdx.x * 256 + threadIdx.x; const int row = idx >> 2, h = idx & 3;
    const float* r = raw + (size_t)row * 512 + h * 128; float ss = 0.f;
    for (int e = 0; e < 128; ++e) ss += r[e] * r[e];
    const float rs = 1.0f / sqrtf(ss * (1.0f / 128.0f) + 1e-6f);
    for (int e = 0; e < 128; ++e) {
        float g = ldf<T>(G + (size_t)row * gpitch + gcol + h * 128 + e);
        if (!gate_is_silu) g = g / (1.0f + expf(-g));
        float y = r[e] * rs; if (mode == 0) y = y * subw[e] * 0.8f;
        Y[(size_t)row * 1024 + ycol + h * 128 + e] = y * g;
    }
}

__global__ __launch_bounds__(256) void n_final(const float* __restrict__ x, const float* __restrict__ yo, const float* __restrict__ w, float* __restrict__ out) {
    const int row = blockIdx.x * 4 + (threadIdx.x >> 6), lane = threadIdx.x & 63;
    const float4* yr = (const float4*)(yo + (size_t)row * ND); const float4* xr = (const float4*)(x + (size_t)row * ND); const float4* wr = (const float4*)w;
    float4 v[4]; float s = 0.f;
#pragma unroll
    for (int j = 0; j < 4; ++j) { v[j] = yr[lane + 64 * j]; s += v[j].x * v[j].x + v[j].y * v[j].y + v[j].z * v[j].z + v[j].w * v[j].w; }
#pragma unroll
    for (int o = 32; o >= 1; o >>= 1) s += __shfl_xor(s, o);
    const float r = 1.0f / sqrtf(s * (1.0f / ND) + 1e-6f);
    float4* orow = (float4*)(out + (size_t)row * ND);
#pragma unroll
    for (int j = 0; j < 4; ++j) { const float4 g = wr[lane + 64 * j], xx = xr[lane + 64 * j]; float4 o; o.x = xx.x + v[j].x * r * g.x; o.y = xx.y + v[j].y * r * g.y; o.z = xx.z + v[j].z * r * g.z; o.w = xx.w + v[j].w * r * g.w; orow[lane + 64 * j] = o; }
}

inline void naive_forward(void* const* d_in, void* d_out, void* d_ws, hipStream_t stream) {
    const float* x = (const float*)d_in[0]; const int* pos = (const int*)d_in[1]; const float* wpre = (const float*)d_in[2]; const float* win = (const float*)d_in[3];
    const float *lq1 = (const float*)d_in[4], *lk1 = (const float*)d_in[5], *lq2 = (const float*)d_in[6], *lk2 = (const float*)d_in[7];
    const float* subw = (const float*)d_in[8]; const float* wout = (const float*)d_in[9]; const float* wpost = (const float*)d_in[10];
    float* U = (float*)d_out; char* ws = (char*)d_ws;
    float* PROJH = (float*)ws; float* Y = (float*)(ws + (128u << 20)); float* RAW = (float*)(ws + (192u << 20)); float* YO = (float*)ws;
    hipLaunchKernelGGL(n_prenorm, dim3(NM / 4), dim3(256), 0, stream, x, wpre, U);
    hipLaunchKernelGGL(n_gemm<float>, dim3(2048 / 64, NM / 64), dim3(256), 0, stream, (const float*)U, ND, win, NPROJ, PROJH, 2048, ND);
    hipLaunchKernelGGL(n_rotary, dim3(NM * 512 / 256), dim3(256), 0, stream, PROJH, 2048, pos, 64);
    hipLaunchKernelGGL(n_diffattn<float>, dim3(NS / 256, 4, NB * 4), dim3(256), 0, stream, (const float*)PROJH, 2048, 0, 512, 1024, 0.125f, lq1, lk1, lq2, lk2, RAW);
    hipLaunchKernelGGL(n_post<float>, dim3(NM * 4 / 256), dim3(256), 0, stream, (const float*)RAW, (const float*)PROJH, 2048, 1536, 0, subw, 0, Y, 0);
    hipLaunchKernelGGL(n_gemm<float>, dim3(2048 / 64, NM / 64), dim3(256), 0, stream, (const float*)U, ND, win + 2048, NPROJ, PROJH, 2048, ND);
    hipLaunchKernelGGL(n_rotary, dim3(NM * 512 / 256), dim3(256), 0, stream, PROJH, 2048, pos, 128);
    hipLaunchKernelGGL(n_ret<float>, dim3(NS / 256, 4, NB * 4), dim3(256), 0, stream, (const float*)PROJH, 2048, 0, 512, 1024, 0.08838834764831845f, RAW);
    hipLaunchKernelGGL(n_post<float>, dim3(NM * 4 / 256), dim3(256), 0, stream, (const float*)RAW, (const float*)PROJH, 2048, 1536, 0, subw, 1, Y, 512);
    hipLaunchKernelGGL(n_gemm<float>, dim3(1024 / 64, NM / 64), dim3(256), 0, stream, (const float*)Y, 1024, wout, 1024, YO, 1024, 1024);
    hipLaunchKernelGGL(n_final, dim3(NM / 4), dim3(256), 0, stream, x, (const float*)YO, wpost, (float*)d_out);
}
}
extern "C" void kernel_launch(void* const* d_in, const int* in_sizes, int n_in, void* d_out, int out_size, void* d_ws, size_t ws_size, hipStream_t stream) {
    nv::naive_forward(d_in, d_out, d_ws, stream);
}
```
